# Optimizing an MI355X kernel written in HIP

```python
import math
import jax, jax.numpy as jnp
from jax import lax
import numpy as np

D_MODEL = 2048
BATCH = 4
SEQ = 2048
DEPTH = 1

SGU_GROUP_DIM = 128
SGU_WIDTH = D_MODEL // 2
SGU_GROUPS = SGU_WIDTH // SGU_GROUP_DIM
CHUNK = 128
HEAD_DIM = 128
N_HEADS = (D_MODEL // 2) // HEAD_DIM
N_KV_HEADS = 2
GQA_GROUP = N_HEADS // N_KV_HEADS
ATT_WIDTH = N_HEADS * HEAD_DIM
KV_WIDTH = N_KV_HEADS * HEAD_DIM
WINDOW = 128
BLOCK = 128
REL_BUCKETS = 32
REL_MAX_DIST = 128
D_FF = ((8 * D_MODEL // 3 + 255) // 256) * 256
EPS = 1e-6
NEG = -1e30

IN_SPLITS = [SGU_WIDTH, SGU_WIDTH, ATT_WIDTH, KV_WIDTH, KV_WIDTH, D_MODEL, D_MODEL]
IN_COLS = int(sum(IN_SPLITS))
IN_OFFSETS = [int(o) for o in np.cumsum(IN_SPLITS)[:-1]]

kernel_name = "hybrid_sgu_swa_gated_encoder"


def rms_norm(x, g):
    xf = x.astype(jnp.float32)
    y = xf * lax.rsqrt(jnp.mean(xf * xf, axis=-1, keepdims=True) + EPS)
    return (y * g.astype(jnp.float32)).astype(x.dtype)


def t5_bucket(rel):
    nb = REL_BUCKETS // 2
    ret = jnp.where(rel > 0, nb, 0)
    n = jnp.abs(rel)
    max_exact = nb // 2
    nf = jnp.maximum(n, 1).astype(jnp.float32)
    large = max_exact + (jnp.log(nf / max_exact) / math.log(REL_MAX_DIST / max_exact)
                         * (nb - max_exact)).astype(jnp.int32)
    large = jnp.minimum(large, nb - 1)
    return ret + jnp.where(n < max_exact, n, large)


def band_structure(seq):
    nblk = seq // BLOCK
    qi = jnp.arange(BLOCK)[:, None]
    kj = jnp.arange(3 * BLOCK)[None, :]
    rel = kj - BLOCK - qi
    key_pos = jnp.arange(nblk)[:, None, None] * BLOCK + kj[None] - BLOCK
    valid = (jnp.abs(rel)[None] <= WINDOW) & (key_pos >= 0) & (key_pos < seq)
    return rel, valid


def band(t, nblk):
    tp = jnp.pad(t, ((0, 0), (BLOCK, BLOCK), (0, 0), (0, 0)))
    tp = tp.reshape(t.shape[0], nblk + 2, BLOCK, t.shape[2], t.shape[3])
    return jnp.concatenate([tp[:, :-2], tp[:, 1:-1], tp[:, 2:]], axis=2)


def windowed_gqa(q, k, v, rel_bias, sink):
    B, S = q.shape[0], q.shape[1]
    nb = S // BLOCK
    q = q.reshape(B, nb, BLOCK, N_KV_HEADS, GQA_GROUP, HEAD_DIM)
    kb = band(k.reshape(B, S, N_KV_HEADS, HEAD_DIM), nb)
    vb = band(v.reshape(B, S, N_KV_HEADS, HEAD_DIM), nb)
    s = jnp.einsum('bnqkgd,bnjkd->bnkgqj', q, kb).astype(jnp.float32) * (HEAD_DIM ** -0.5)
    rel, valid = band_structure(S)
    bias = rel_bias.astype(jnp.float32)[t5_bucket(rel)]
    bias = bias.transpose(2, 0, 1).reshape(N_KV_HEADS, GQA_GROUP, BLOCK, 3 * BLOCK)
    s = jnp.where(valid[None, :, None, None], s + bias, NEG)
    sink_logit = jnp.broadcast_to(
        sink.astype(jnp.float32).reshape(N_KV_HEADS, GQA_GROUP)[None, None, :, :, None, None],
        s.shape[:-1] + (1,))
    p = jax.nn.softmax(jnp.concatenate([s, sink_logit], axis=-1), axis=-1)[..., :-1]
    o = jnp.einsum('bnkgqj,bnjkd->bnqkgd', p.astype(vb.dtype), vb)
    return o.reshape(B, S, ATT_WIDTH)


def chunked_sgu(u, v, v_gain, w_s, b_s):
    B, S = u.shape[0], u.shape[1]
    nc = S // CHUNK
    v = rms_norm(v, v_gain).reshape(B, nc, CHUNK, SGU_GROUPS, SGU_GROUP_DIM)
    mixed = jnp.einsum('gpq,bcqge->bcpge', w_s, v) + b_s.T[:, :, None]
    return u * mixed.reshape(B, S, SGU_WIDTH)


def setup_inputs(seed: int = 0) -> dict:
    key = jax.random.key(seed)
    ks = jax.random.split(key, 20)
    f32 = jnp.float32

    def nrm(k, shape, scale):
        return jax.random.normal(k, shape, f32) * scale

    return {
        "x": nrm(ks[0], (BATCH, SEQ, D_MODEL), 1.0),
        "w_in": nrm(ks[1], (DEPTH, D_MODEL, IN_COLS), D_MODEL ** -0.5),
        "norm_mix": 1.0 + nrm(ks[2], (DEPTH, D_MODEL), 0.05),
        "sgu_v_gain": 1.0 + nrm(ks[3], (DEPTH, SGU_WIDTH), 0.05),
        "sgu_w_s": nrm(ks[4], (DEPTH, SGU_GROUPS, CHUNK, CHUNK), 0.5 * CHUNK ** -0.5),
        "sgu_b_s": 1.0 + nrm(ks[5], (DEPTH, SGU_GROUPS, CHUNK), 0.1),
        "w_a_out": nrm(ks[6], (DEPTH, SGU_WIDTH, D_MODEL), SGU_WIDTH ** -0.5),
        "attn_sink": nrm(ks[7], (DEPTH, N_HEADS), 0.5),
        "rel_bias": nrm(ks[8], (REL_BUCKETS, N_HEADS), 0.5),
        "w_b_out": nrm(ks[9], (DEPTH, ATT_WIDTH, D_MODEL), ATT_WIDTH ** -0.5),
        "w_o": nrm(ks[10], (DEPTH, D_MODEL, D_MODEL), D_MODEL ** -0.5),
        "norm_ffn": 1.0 + nrm(ks[11], (DEPTH, D_MODEL), 0.05),
        "w_gate": nrm(ks[12], (DEPTH, D_MODEL, D_FF), D_MODEL ** -0.5),
        "w_up": nrm(ks[13], (DEPTH, D_MODEL, D_FF), D_MODEL ** -0.5),
        "w_down": nrm(ks[14], (DEPTH, D_FF, D_MODEL), D_FF ** -0.5),
        "norm_final": 1.0 + nrm(ks[15], (D_MODEL,), 0.05),
    }


def reference(x, w_in, norm_mix, sgu_v_gain, sgu_w_s, sgu_b_s, w_a_out, attn_sink, rel_bias,
              w_b_out, w_o, norm_ffn, w_gate, w_up, w_down, norm_final):
    for l in range(DEPTH):
        h = rms_norm(x, norm_mix[l])
        z = h @ w_in[l]
        zu, zv, q, k, v, ga, gb = jnp.split(z, IN_OFFSETS, axis=-1)
        y_a = chunked_sgu(jax.nn.gelu(zu), jax.nn.gelu(zv), sgu_v_gain[l],
                          sgu_w_s[l], sgu_b_s[l]) @ w_a_out[l]
        y_b = windowed_gqa(q, k, v, rel_bias, attn_sink[l]) @ w_b_out[l]
        m = jax.nn.sigmoid(ga) * y_a + jax.nn.sigmoid(gb) * y_b
        x = x + m @ w_o[l]
        h = rms_norm(x, norm_ffn[l])
        x = x + (jax.nn.silu(h @ w_gate[l]) * (h @ w_up[l])) @ w_down[l]
    return rms_norm(x, norm_final)
```

```cpp
#include <hip/hip_runtime.h>
#include <cstdio>
#include <cstdint>

#ifndef MK_N_LAUNCHES
#define MK_N_LAUNCHES 8
#endif

#define LAS __attribute__((address_space(3)))
#define GAS __attribute__((address_space(1)))
typedef unsigned short bf16_t;
typedef short bf16x8 __attribute__((ext_vector_type(8)));
typedef float f32x4 __attribute__((ext_vector_type(4)));
typedef float f32x2 __attribute__((ext_vector_type(2)));
typedef unsigned u32x4 __attribute__((ext_vector_type(4)));
typedef unsigned u32x2 __attribute__((ext_vector_type(2)));

constexpr int NB = 4, SEQ = 2048, DM = 2048, MTOK = NB * SEQ;
constexpr int NIN = 7680, DFF = 5632, NGU = 2 * DFF;
constexpr int ZA_LD = 3584, ZG_LD = 4096;
constexpr int ZC_U = 0, ZC_V = 1024, ZC_Q = 2048, ZC_K = 3072, ZC_VV = 3328, ZG_GA = 0, ZG_GB = 2048;
constexpr float EPS = 1e-6f;
constexpr float LOG2E = 1.4426950408889634f;

constexpr size_t MiB = 1u << 20;
constexpr size_t WS_CTL = 0, CTL_ZERO_BYTES = 64 * 1024;
constexpr size_t WS_RSTD1 = 1 * MiB;
constexpr size_t WS_VSS = WS_RSTD1 + 64 * 1024;
constexpr size_t WS_X1SS = WS_VSS + 512 * 1024;
constexpr size_t WS_X2SS = WS_X1SS + 256 * 1024;
constexpr size_t WS_WIN = 2 * MiB;
constexpr size_t WS_WAB = WS_WIN + 30 * MiB;
constexpr size_t WS_WO = WS_WAB + 8 * MiB;
constexpr size_t WS_WGU = WS_WO + 8 * MiB;
constexpr size_t WS_WD = WS_WGU + 44 * MiB;
constexpr size_t WS_R1 = WS_WD + 22 * MiB;
constexpr size_t WS_R2 = WS_R1 + 32 * MiB;
constexpr size_t WS_ZG = WS_R2 + 56 * MiB;
constexpr size_t WS_END = WS_R2 + 120 * MiB;

constexpr int RING_BYTES = 131072;
constexpr int SPARE_OFF = RING_BYTES;
constexpr int MISC_OFF = SPARE_OFF + 8192;
constexpr int LDS_BYTES = 147456;
constexpr int NWAVES = 8;

__device__ __forceinline__ unsigned cvt_pk_bf16(float lo, float hi) { unsigned r; asm volatile("v_cvt_pk_bf16_f32 %0, %1, %2" : "=v"(r) : "v"(lo), "v"(hi)); return r; }
__device__ __forceinline__ float bf_lo(unsigned w) { return __uint_as_float(w << 16); }
__device__ __forceinline__ float bf_hi(unsigned w) { return __uint_as_float(w & 0xffff0000u); }
__device__ __forceinline__ float fast_sigmoid(float x) { return __builtin_amdgcn_rcpf(1.0f + __builtin_amdgcn_exp2f(-LOG2E * x)); }
__device__ __forceinline__ float gelu_tanh(float x) {
    const float u = x * (1.0f + 0.044715f * x * x);
    return x * __builtin_amdgcn_rcpf(1.0f + __builtin_amdgcn_exp2f(-2.0f * 0.7978845608028654f * LOG2E * u));
}
__device__ __forceinline__ float silu_f(float x) { return x * fast_sigmoid(x); }
#define LDS_WAIT() asm volatile("s_waitcnt lgkmcnt(0)" ::: "memory")
#define VM_WAIT() asm volatile("s_waitcnt vmcnt(0)" ::: "memory")

namespace pg8 {
constexpr int BM = 256, BK = 64, HALF = 128, HTB = HALF * BK * 2, STAGE_BYTES = 8 * HTB, NXCD = 8, WGM = 8;
__host__ __device__ __forceinline__ int lds_byte(int r, int c) { const int st = (r >> 4) * 2 + (c >> 5), rr = r & 15, cc = c & 31, ob = rr * 64 + cc * 2; return st * 1024 + (ob ^ (((ob >> 9) & 1) << 5)); }
__host__ __device__ __forceinline__ void stage_rc(int b, int& R, int& C) { const int st = b / 1024, sb = b % 1024, swz = sb ^ (((sb >> 9) & 1) << 5); R = (st >> 1) * 16 + swz / 64; C = (st & 1) * 32 + (swz % 64) / 2; }
__host__ __device__ __forceinline__ int perm32(int rho) { const int n = rho >> 4, i = rho & 15; return 8 * (i >> 2) + 4 * n + (i & 3); }

struct Unit { int pm, pn; };
struct Gemm { const bf16_t* A; const bf16_t* Bt; int M, N, K; };

struct StaticOrder {
    int nM, nN, nwg, G, c;
    __host__ __device__ void init(int M, int N, int G_, int c_) { nM = M / BM; nN = N / BM; nwg = nM * nN; G = G_; c = c_; }
    __host__ __device__ bool next(int i, Unit& u) const {
        const long L = (long)i * G + c; if (L >= nwg) return false;
        int wgid = (int)L; { const int q = nwg / NXCD, r = nwg % NXCD, xcd = wgid % NXCD, off = wgid / NXCD; wgid = (xcd < r ? xcd * (q + 1) : r * (q + 1) + (xcd - r) * q) + off; }
        const int nig = WGM * nN, gid = wgid / nig, fm = gid * WGM, gsz = (nM - fm) < WGM ? (nM - fm) : WGM;
        u.pm = fm + ((wgid % nig) % gsz); u.pn = (wgid % nig) / gsz; return true;
    }
};

template <class Epi>
__device__ __forceinline__ void gemm_phase(LAS unsigned char* lds, const Gemm g, const StaticOrder& S, const Epi& E) {
    const int tid = threadIdx.x, wid = __builtin_amdgcn_readfirstlane(tid >> 6), lane = tid & 63, wr = wid >> 2, wc = wid & 3, fr = lane & 15, fq = lane >> 4;
    const int K = g.K, nt = K / BK;
    unsigned voffA[2], voffB[2];
#pragma unroll
    for (int i = 0; i < 2; ++i) { int R, C; stage_rc(tid * 16 + i * 8192, R, C); const int Rb = (R & ~31) + perm32(R & 31);
        voffA[i] = (unsigned)(R * K + C) * 2u; voffB[i] = (unsigned)(Rb * K + C) * 2u; }
    const size_t kstep = (size_t)(BK * 2);
    const size_t hstep = (size_t)HALF * K * 2;
    const size_t tstep = 2 * hstep;
    const unsigned ldsw = (unsigned)wid * 1024u;
    const int aoff = lds_byte(wr * 64 + fr, fq * 8), boff = lds_byte(wc * 32 + fr, fq * 8);
#define PG8_SA(b, h) (((b) * 2 + (h)) * HTB)
#define PG8_SB(b, h) ((4 + (b) * 2 + (h)) * HTB)
#define PG8_STAGE(bufoff, gbase, voff) do { _Pragma("unroll") for (int _i = 0; _i < 2; ++_i) \
        __builtin_amdgcn_global_load_lds((const unsigned*)((const char*)(gbase) + (voff)[_i]), (LAS unsigned*)(lds + (bufoff) + ldsw + _i * 8192), 16, 0, 0); } while (0)
#define PG8_LDA(dst, b, h) do { _Pragma("unroll") for (int m = 0; m < 4; ++m) _Pragma("unroll") for (int k = 0; k < 2; ++k) dst[m][k] = *(const LAS bf16x8*)(lds + PG8_SA(b, h) + aoff + m * 2048 + k * 1024); } while (0)
#define PG8_LDB(dst, b, h) do { _Pragma("unroll") for (int n = 0; n < 2; ++n) _Pragma("unroll") for (int k = 0; k < 2; ++k) dst[n][k] = *(const LAS bf16x8*)(lds + PG8_SB(b, h) + boff + n * 2048 + k * 1024); } while (0)
#define PG8_MMA(ai, bj, At, Bt) do { __builtin_amdgcn_s_setprio(1); _Pragma("unroll") for (int m = 0; m < 4; ++m) _Pragma("unroll") for (int n = 0; n < 2; ++n) _Pragma("unroll") for (int k = 0; k < 2; ++k) \
        acc[ai][bj][m][n] = __builtin_amdgcn_mfma_f32_16x16x32_bf16(Bt[n][k], At[m][k], acc[ai][bj][m][n], 0, 0, 0); __builtin_amdgcn_s_setprio(0); } while (0)
#define PG8_WAIT_V(n) asm volatile("s_waitcnt vmcnt(" #n ")" ::: "memory")
#define PG8_WAIT_L(n) asm volatile("s_waitcnt lgkmcnt(" #n ")" ::: "memory")
#define PG8_BAR __builtin_amdgcn_s_barrier()
#define PG8_SCHED __builtin_amdgcn_sched_barrier(0)
    Unit cur, nxt; int ui = 0;
    if (!S.next(0, cur)) return;
    f32x4 acc[2][2][4][2];
#pragma unroll
    for (int a = 0; a < 2; ++a)
#pragma unroll
        for (int b = 0; b < 2; ++b)
#pragma unroll
            for (int m = 0; m < 4; ++m)
#pragma unroll
                for (int n = 0; n < 2; ++n) acc[a][b][m][n] = (f32x4){0.f, 0.f, 0.f, 0.f};
    bf16x8 At[4][2], B0[2][2], B1[2][2];
    const char* cA = (const char*)g.A + (size_t)cur.pm * tstep; const char* cB = (const char*)g.Bt + (size_t)cur.pn * tstep;
    PG8_STAGE(PG8_SB(0, 0), cB, voffB); PG8_STAGE(PG8_SB(0, 1), cB + hstep, voffB); PG8_STAGE(PG8_SA(0, 0), cA, voffA); PG8_STAGE(PG8_SA(0, 1), cA + hstep, voffA);
    if (wr == 1) PG8_BAR;
    PG8_WAIT_V(2); PG8_BAR;
    PG8_STAGE(PG8_SB(1, 0), cB + kstep, voffB); PG8_STAGE(PG8_SA(1, 0), cA + kstep, voffA); PG8_STAGE(PG8_SB(1, 1), cB + hstep + kstep, voffB);
    PG8_WAIT_V(6); PG8_BAR;
    for (;;) {
        const bool has_next = S.next(ui + 1, nxt);
        const char* nA = has_next ? (const char*)g.A + (size_t)nxt.pm * tstep : cA; const char* nB = has_next ? (const char*)g.Bt + (size_t)nxt.pn * tstep : cB;
        for (int t = 0; t < nt; t += 2) {
            const bool last = (t == nt - 2);
            const char* a1 = cA + (size_t)(t + 1) * kstep;
            const char* a2 = last ? nA : cA + (size_t)(t + 2) * kstep; const char* b2 = last ? nB : cB + (size_t)(t + 2) * kstep;
            const char* a3 = a2 + kstep; const char* b3 = b2 + kstep;
            if constexpr (Epi::HAS_MID) { if (t == E.tmid) E.mid(acc, cur, wr, wc, fr, fq); }
            PG8_LDB(B0, 0, 0); PG8_LDB(B1, 0, 1); PG8_SCHED; PG8_LDA(At, 0, 0); PG8_STAGE(PG8_SA(1, 1), a1 + hstep, voffA);
            PG8_WAIT_V(8); PG8_WAIT_L(0); PG8_BAR; PG8_MMA(0, 0, At, B0); PG8_MMA(0, 1, At, B1); PG8_BAR; PG8_SCHED;
            PG8_LDA(At, 0, 1); PG8_STAGE(PG8_SB(0, 0), b2, voffB); PG8_STAGE(PG8_SB(0, 1), b2 + hstep, voffB); PG8_STAGE(PG8_SA(0, 0), a2, voffA);
            PG8_WAIT_V(8); PG8_WAIT_L(0); PG8_BAR; PG8_MMA(1, 0, At, B0); PG8_MMA(1, 1, At, B1); PG8_BAR; PG8_SCHED;
            PG8_LDB(B0, 1, 0); PG8_LDB(B1, 1, 1); PG8_SCHED; PG8_LDA(At, 1, 0); PG8_STAGE(PG8_SA(0, 1), a2 + hstep, voffA);
            PG8_WAIT_V(8); PG8_WAIT_L(0); PG8_BAR; PG8_MMA(0, 0, At, B0); PG8_MMA(0, 1, At, B1); PG8_BAR; PG8_SCHED;
            PG8_LDA(At, 1, 1); PG8_STAGE(PG8_SB(1, 0), b3, voffB); PG8_STAGE(PG8_SB(1, 1), b3 + hstep, voffB); PG8_STAGE(PG8_SA(1, 0), a3, voffA);
            PG8_WAIT_V(8); PG8_WAIT_L(0); PG8_BAR; PG8_MMA(1, 0, At, B0); PG8_MMA(1, 1, At, B1); PG8_BAR; PG8_SCHED;
        }
        if (wr == 0) PG8_BAR;
        E(acc, cur, wr, wc, fr, fq, lds + SPARE_OFF);
        if (!has_next) break;
#pragma unroll
        for (int a = 0; a < 2; ++a)
#pragma unroll
            for (int b = 0; b < 2; ++b)
#pragma unroll
                for (int m = 0; m < 4; ++m)
#pragma unroll
                    for (int n = 0; n < 2; ++n) acc[a][b][m][n] = (f32x4){0.f, 0.f, 0.f, 0.f};
        cur = nxt; cA = nA; cB = nB; ++ui;
        if (wr == 1) PG8_BAR;
    }
    PG8_WAIT_V(0);
    PG8_BAR;
#undef PG8_SA
#undef PG8_SB
#undef PG8_STAGE
#undef PG8_LDA
#undef PG8_LDB
#undef PG8_MMA
#undef PG8_WAIT_V
#undef PG8_WAIT_L
#undef PG8_BAR
#undef PG8_SCHED
}
}

typedef f32x4 Acc[2][2][4][2];

struct Epi1 {
    static constexpr bool HAS_MID = false; int tmid;
    bf16_t* ZA; bf16_t* ZG; const float* rstd; float* vss;
    __device__ __forceinline__ void mid(Acc&, const pg8::Unit&, int, int, int, int) const {}
    __device__ __forceinline__ void operator()(const Acc& acc, const pg8::Unit& u, int wr, int wc, int fr, int fq, LAS unsigned char*) const {
        const int pn = u.pn, seg = pn < 4 ? 0 : (pn < 8 ? 1 : (pn < 14 ? 2 : 3));
        const int row0 = u.pm * 256 + wr * 64 + fr, col0 = (pn < 14 ? pn * 256 : (pn - 14) * 256) + wc * 32 + 8 * fq;
        bf16_t* Zb = pn < 14 ? ZA : ZG; const int ld = pn < 14 ? ZA_LD : ZG_LD;
#pragma unroll
        for (int ai = 0; ai < 2; ++ai)
#pragma unroll
            for (int m = 0; m < 4; ++m) {
                const int row = row0 + ai * 128 + m * 16; const float rs = rstd[row]; float ss = 0.f;
                bf16_t* rowp = Zb + (size_t)row * ld + col0;
#pragma unroll
                for (int bj = 0; bj < 2; ++bj) {
                    float v[8];
#pragma unroll
                    for (int j = 0; j < 4; ++j) { v[j] = acc[ai][bj][m][0][j] * rs; v[4 + j] = acc[ai][bj][m][1][j] * rs; }
                    if (seg <= 1) {
#pragma unroll
                        for (int j = 0; j < 8; ++j) v[j] = gelu_tanh(v[j]);
                        if (seg == 1) {
#pragma unroll
                            for (int j = 0; j < 8; ++j) ss += v[j] * v[j];
                        }
                    } else if (seg == 3) {
#pragma unroll
                        for (int j = 0; j < 8; ++j) v[j] = fast_sigmoid(v[j]);
                    }
                    u32x4 w; w.x = cvt_pk_bf16(v[0], v[1]); w.y = cvt_pk_bf16(v[2], v[3]); w.z = cvt_pk_bf16(v[4], v[5]); w.w = cvt_pk_bf16(v[6], v[7]);
                    *(u32x4*)(rowp + bj * 128) = w;
                }
                if (seg == 1) { ss += __shfl_xor(ss, 16); ss += __shfl_xor(ss, 32); if (fq == 0) vss[(size_t)row * 16 + (pn - 4) * 4 + wc] = ss; }
            }
    }
};

struct Epi3 {
    static constexpr bool HAS_MID = true; int tmid;
    const bf16_t* ZG; bf16_t* Mm;
    __device__ __forceinline__ void mid(Acc& acc, const pg8::Unit& u, int wr, int wc, int fr, int fq) const {
        int row0 = u.pm * 256 + wr * 64 + fr, col0 = u.pn * 256 + wc * 32 + 8 * fq;
        asm volatile("" : "+v"(row0), "+v"(col0));
#pragma unroll
        for (int ai = 0; ai < 2; ++ai)
#pragma unroll
            for (int m = 0; m < 4; ++m) {
                const bf16_t* rowp = ZG + (size_t)(row0 + ai * 128 + m * 16) * ZG_LD + col0;
#pragma unroll
                for (int bj = 0; bj < 2; ++bj) {
                    const u32x4 a = *(const u32x4*)(rowp + ZG_GA + bj * 128), b = *(const u32x4*)(rowp + ZG_GB + bj * 128);
#pragma unroll
                    for (int w = 0; w < 4; ++w) {
                        const float r0 = bf_lo(a[w]) * __builtin_amdgcn_rcpf(fmaxf(bf_lo(b[w]), 1e-30f)), r1 = bf_hi(a[w]) * __builtin_amdgcn_rcpf(fmaxf(bf_hi(b[w]), 1e-30f));
                        acc[ai][bj][m][w >> 1][(w & 1) * 2] *= r0; acc[ai][bj][m][w >> 1][(w & 1) * 2 + 1] *= r1;
                    }
                }
                asm volatile("" ::: "memory");
            }
    }
    __device__ __forceinline__ void operator()(const Acc& acc, const pg8::Unit& u, int wr, int wc, int fr, int fq, LAS unsigned char*) const {
        const int row0 = u.pm * 256 + wr * 64 + fr, col0 = u.pn * 256 + wc * 32 + 8 * fq;
#pragma unroll
        for (int ai = 0; ai < 2; ++ai)
#pragma unroll
            for (int m = 0; m < 4; ++m) {
                const int row = row0 + ai * 128 + m * 16;
                const bf16_t* zp = ZG + (size_t)row * ZG_LD + ZG_GB + col0; bf16_t* op = Mm + (size_t)row * DM + col0;
#pragma unroll
                for (int bj = 0; bj < 2; ++bj) {
                    const u32x4 b = *(const u32x4*)(zp + bj * 128); u32x4 w;
#pragma unroll
                    for (int q = 0; q < 4; ++q)
                        w[q] = cvt_pk_bf16(acc[ai][bj][m][q >> 1][(q & 1) * 2] * bf_lo(b[q]), acc[ai][bj][m][q >> 1][(q & 1) * 2 + 1] * bf_hi(b[q]));
                    *(u32x4*)(op + bj * 128) = w;
                }
                asm volatile("" ::: "memory");
            }
    }
};

template <bool WITH_BF16> struct EpiRes {
    static constexpr bool HAS_MID = false; int tmid;
    const float* base; float* out; bf16_t* outb; float* ss;
    __device__ __forceinline__ void mid(Acc&, const pg8::Unit&, int, int, int, int) const {}
    __device__ __forceinline__ void operator()(const Acc& acc, const pg8::Unit& u, int wr, int wc, int fr, int fq, LAS unsigned char* spare) const {
        const int row0 = u.pm * 256 + wr * 64 + fr, col0 = u.pn * 256 + wc * 32 + 8 * fq;
        LAS float* P = (LAS float*)spare;
#pragma unroll
        for (int ai = 0; ai < 2; ++ai)
#pragma unroll
            for (int m = 0; m < 4; ++m) {
                const int rl = ai * 128 + wr * 64 + m * 16 + fr; const size_t off = (size_t)(row0 + ai * 128 + m * 16) * DM + col0; float s = 0.f;
#pragma unroll
                for (int bj = 0; bj < 2; ++bj) {
                    const f32x4 xa = *(const f32x4*)(base + off + bj * 128), xb = *(const f32x4*)(base + off + bj * 128 + 4);
                    const f32x4 v0 = acc[ai][bj][m][0] + xa, v1 = acc[ai][bj][m][1] + xb;
                    *(f32x4*)(out + off + bj * 128) = v0; *(f32x4*)(out + off + bj * 128 + 4) = v1;
                    if (WITH_BF16) { u32x4 w; w.x = cvt_pk_bf16(v0[0], v0[1]); w.y = cvt_pk_bf16(v0[2], v0[3]); w.z = cvt_pk_bf16(v1[0], v1[1]); w.w = cvt_pk_bf16(v1[2], v1[3]);
                        *(u32x4*)(outb + off + bj * 128) = w; }
                    s += (v0[0] * v0[0] + v0[1] * v0[1]) + (v0[2] * v0[2] + v0[3] * v0[3]) + (v1[0] * v1[0] + v1[1] * v1[1]) + (v1[2] * v1[2] + v1[3] * v1[3]);
                }
                s += __shfl_xor(s, 16); s += __shfl_xor(s, 32);
                if (fq == 0) P[rl * 4 + wc] = s;
            }
        LDS_WAIT(); __builtin_amdgcn_s_barrier(); asm volatile("" ::: "memory");
        const int t = threadIdx.x;
        if (t < 256) { const f32x4 p = *(const LAS f32x4*)(P + t * 4); ss[(size_t)(u.pm * 256 + t) * 8 + u.pn] = (p[0] + p[1]) + (p[2] + p[3]); }
    }
};

struct Epi5 {
    static constexpr bool HAS_MID = false; int tmid;
    const float* ss; bf16_t* act;
    __device__ __forceinline__ void mid(Acc&, const pg8::Unit&, int, int, int, int) const {}
    __device__ __forceinline__ void operator()(const Acc& acc, const pg8::Unit& u, int wr, int wc, int fr, int fq, LAS unsigned char*) const {
        const int row0 = u.pm * 256 + wr * 64 + fr, col0 = u.pn * 128 + wc * 32 + 8 * fq;
#pragma unroll
        for (int ai = 0; ai < 2; ++ai)
#pragma unroll
            for (int m = 0; m < 4; ++m) {
                const int row = row0 + ai * 128 + m * 16;
                const f32x4 pa = *(const f32x4*)(ss + (size_t)row * 8), pb = *(const f32x4*)(ss + (size_t)row * 8 + 4);
                const float rs = __builtin_amdgcn_rsqf(((pa[0] + pa[1]) + (pa[2] + pa[3]) + (pb[0] + pb[1]) + (pb[2] + pb[3])) * (1.0f / DM) + EPS);
                float y[8];
#pragma unroll
                for (int j = 0; j < 4; ++j) { y[j] = silu_f(acc[ai][0][m][0][j] * rs) * (acc[ai][1][m][0][j] * rs); y[4 + j] = silu_f(acc[ai][0][m][1][j] * rs) * (acc[ai][1][m][1][j] * rs); }
                u32x4 w; w.x = cvt_pk_bf16(y[0], y[1]); w.y = cvt_pk_bf16(y[2], y[3]); w.z = cvt_pk_bf16(y[4], y[5]); w.w = cvt_pk_bf16(y[6], y[7]);
                *(u32x4*)(act + (size_t)row * DFF + col0) = w;
            }
    }
};

#define XB_TMO      128
#define XB_XCNT(j)  (256  + 64 * (j))
#define XB_XSUB(j)  (1280 + 64 * (j))
#define XB_XGEN(j)  (2304 + 64 * (j))
#define XB_TOP      3328
#define XB_TOPGEN   3392
#define XCD_BAR_WORDS 3456
#define XB_SPIN_CAP (1u << 22)
__device__ __forceinline__ unsigned xb_ld(unsigned* p)              { return __hip_atomic_load(p, __ATOMIC_RELAXED, __HIP_MEMORY_SCOPE_AGENT); }
__device__ __forceinline__ unsigned xb_add(unsigned* p, unsigned v) { return __hip_atomic_fetch_add(p, v, __ATOMIC_RELAXED, __HIP_MEMORY_SCOPE_AGENT); }
__device__ __forceinline__ unsigned xb_xcc_id() { return (unsigned)__builtin_amdgcn_s_getreg((3 << 11) | 20) & 0xFu; }
#define XB_SPIN(cond, bar) do { unsigned _sp = 0; while (cond) { __builtin_amdgcn_s_sleep(1); \
    if ((++_sp & 255u) == 0u) { if (xb_ld(&(bar)[XB_TMO])) break; if (_sp > XB_SPIN_CAP) { atomicAdd(&(bar)[XB_TMO], 1u); break; } } } } while (0)
struct XcdBarrier { unsigned* bar; unsigned x; volatile LAS unsigned* st; };
__device__ __forceinline__ XcdBarrier xcd_barrier_post(unsigned* bar, volatile LAS unsigned* st) {
    XcdBarrier b; b.bar = bar; b.x = xb_xcc_id(); b.st = st;
    if (threadIdx.x == 0) (void)xb_add(&bar[XB_XCNT(b.x)], 1u);
    return b;
}
__device__ __forceinline__ void xcd_barrier_complete(unsigned* bar, unsigned x, unsigned& nloc, unsigned& nx) {
    const unsigned G = gridDim.x * gridDim.y * gridDim.z;
    unsigned sum, cnt, mine, sp = 0u;
    for (;;) {
        sum = 0u; cnt = 0u; mine = 0u;
#pragma unroll
        for (unsigned j = 0; j < 16; ++j) { const unsigned c = xb_ld(&bar[XB_XCNT(j)]); sum += c; cnt += (c > 0u) ? 1u : 0u; mine = (j == x) ? c : mine; }
        if (sum == G) break;
        __builtin_amdgcn_s_sleep(1);
        if ((++sp & 255u) == 0u) { if (xb_ld(&bar[XB_TMO])) break; if (sp > XB_SPIN_CAP) { atomicAdd(&bar[XB_TMO], 1u); break; } }
    }
    nloc = mine > 0u ? mine : 1u; nx = cnt > 0u ? cnt : 1u;
}
__device__ __forceinline__ void xcd_barrier(const XcdBarrier& b) {
    asm volatile("s_waitcnt vmcnt(0)" ::: "memory");
    __syncthreads();
    if (threadIdx.x == 0) {
        unsigned* bar = b.bar;
        __builtin_amdgcn_s_waitcnt(0);
        unsigned nloc = b.st[0], nx = b.st[1];
        if (nloc == 0u) { xcd_barrier_complete(bar, b.x, nloc, nx); b.st[0] = nloc; b.st[1] = nx; }
        const unsigned old = xb_add(&bar[XB_XSUB(b.x)], 1u);
        const unsigned gen = old / nloc;
        if (old + 1u == (gen + 1u) * nloc) {
            __builtin_amdgcn_fence(__ATOMIC_RELEASE, "agent");
            asm volatile("s_waitcnt vmcnt(0)" ::: "memory");
            const unsigned og = xb_add(&bar[XB_TOP], 1u);
            const unsigned tg = og / nx;
            if (og + 1u == (tg + 1u) * nx) xb_add(&bar[XB_TOPGEN], 1u);
            else XB_SPIN(xb_ld(&bar[XB_TOPGEN]) == tg, bar);
            __builtin_amdgcn_fence(__ATOMIC_ACQUIRE, "agent");
            xb_add(&bar[XB_XGEN(b.x)], 1u);
            asm volatile("s_waitcnt vmcnt(0)" ::: "memory");
        } else {
            XB_SPIN(xb_ld(&bar[XB_XGEN(b.x)]) == gen, bar);
            __builtin_amdgcn_fence(__ATOMIC_ACQUIRE, "agent");
            asm volatile("s_waitcnt vmcnt(0)" ::: "memory");
        }
    }
    __syncthreads();
}

struct Args {
    const float* in[16]; float* out; unsigned char* ws; int ph_lo, ph_hi;
};

__device__ __forceinline__ float wave_sum(float v) {
#pragma unroll
    for (int o = 1; o < 64; o <<= 1) v += __shfl_xor(v, o);
    return v;
}

__device__ __forceinline__ void transpose_item(const float* __restrict__ W, int N, const float* __restrict__ sc, bf16_t* WT, int ldk, int kcol0,
                                               int k0, int n0, int drow0, LAS unsigned* scr, int lane) {
    const int nl4 = (lane & 15) * 4, kq = lane >> 4;
#pragma unroll
    for (int i = 0; i < 8; ++i) {
        const int kk = 8 * i + 2 * kq;
        f32x4 a = *(const f32x4*)(W + (size_t)(k0 + kk) * N + n0 + nl4), b = *(const f32x4*)(W + (size_t)(k0 + kk + 1) * N + n0 + nl4);
        if (sc) { const float s0 = sc[k0 + kk], s1 = sc[k0 + kk + 1]; a = a * s0; b = b * s1; }
#pragma unroll
        for (int j = 0; j < 4; ++j) scr[(nl4 + j) * 33 + 4 * i + kq] = cvt_pk_bf16(a[j], b[j]);
    }
    LDS_WAIT(); asm volatile("" ::: "memory");
    const int c = lane & 7;
#pragma unroll
    for (int jj = 0; jj < 8; ++jj) {
        const int n = (lane >> 3) + 8 * jj; const LAS unsigned* s = scr + n * 33 + 4 * c;
        u32x4 o; o.x = s[0]; o.y = s[1]; o.z = s[2]; o.w = s[3];
        *(u32x4*)(WT + (size_t)(drow0 + n) * ldk + kcol0 + k0 + 8 * c) = o;
    }
    LDS_WAIT(); asm volatile("" ::: "memory");
}

__device__ __forceinline__ void p0_prologue(const Args& A, LAS unsigned char* lds, int wave, int lane) {
    unsigned char* ws = A.ws;
    LAS unsigned* scr = (LAS unsigned*)(lds + wave * 16384);
    const int gw = blockIdx.x * NWAVES + wave, NGW = gridDim.x * NWAVES;
    const float* w_in = A.in[1]; const float* norm_mix = A.in[2]; const float* w_a = A.in[6]; const float* w_b = A.in[9]; const float* w_o = A.in[10];
    const float* norm_ffn = A.in[11]; const float* w_gate = A.in[12]; const float* w_up = A.in[13]; const float* w_down = A.in[14];
    bf16_t* Win = (bf16_t*)(ws + WS_WIN); bf16_t* Wab = (bf16_t*)(ws + WS_WAB); bf16_t* Wo = (bf16_t*)(ws + WS_WO); bf16_t* Wgu = (bf16_t*)(ws + WS_WGU); bf16_t* Wd = (bf16_t*)(ws + WS_WD);
    constexpr int I_IN = (DM / 64) * (NIN / 64), I_A = (1024 / 64) * (DM / 64), I_O = (DM / 64) * (DM / 64), I_G = (DM / 64) * (DFF / 64), I_D = (DFF / 64) * (DM / 64);
    constexpr int NITEMS = I_IN + 2 * I_A + I_O + 2 * I_G + I_D;
    for (int it = gw; it < NITEMS; it += NGW) {
        int r = it;
        if (r < I_IN) { const int nb = NIN / 64, kb = r / nb, nn = r % nb; transpose_item(w_in, NIN, norm_mix, Win, DM, 0, 64 * kb, 64 * nn, 64 * nn, scr, lane); continue; } r -= I_IN;
        if (r < I_A) { const int nb = DM / 64, kb = r / nb, nn = r % nb; transpose_item(w_a, DM, nullptr, Wab, DM, 0, 64 * kb, 64 * nn, 64 * nn, scr, lane); continue; } r -= I_A;
        if (r < I_A) { const int nb = DM / 64, kb = r / nb, nn = r % nb; transpose_item(w_b, DM, nullptr, Wab, DM, 1024, 64 * kb, 64 * nn, 64 * nn, scr, lane); continue; } r -= I_A;
        if (r < I_O) { const int nb = DM / 64, kb = r / nb, nn = r % nb; transpose_item(w_o, DM, nullptr, Wo, DM, 0, 64 * kb, 64 * nn, 64 * nn, scr, lane); continue; } r -= I_O;
        if (r < I_G) { const int nb = DFF / 64, kb = r / nb, nn = r % nb, n0 = 64 * nn; transpose_item(w_gate, DFF, norm_ffn, Wgu, DM, 0, 64 * kb, n0, 256 * (n0 >> 7) + (n0 & 127), scr, lane); continue; } r -= I_G;
        if (r < I_G) { const int nb = DFF / 64, kb = r / nb, nn = r % nb, n0 = 64 * nn; transpose_item(w_up, DFF, norm_ffn, Wgu, DM, 0, 64 * kb, n0, 256 * (n0 >> 7) + 128 + (n0 & 127), scr, lane); continue; } r -= I_G;
        { const int nb = DM / 64, kb = r / nb, nn = r % nb; transpose_item(w_down, DM, nullptr, Wd, DFF, 0, 64 * kb, 64 * nn, 64 * nn, scr, lane); }
    }
    const float* x = A.in[0]; bf16_t* XB = (bf16_t*)(ws + WS_R1); float* rstd1 = (float*)(ws + WS_RSTD1);
    for (int m = gw; m < MTOK; m += NGW) {
        const f32x4* xr = (const f32x4*)(x + (size_t)m * DM) + lane; f32x4 v[8]; float s = 0.f;
#pragma unroll
        for (int j = 0; j < 8; ++j) { v[j] = xr[64 * j]; s += (v[j][0] * v[j][0] + v[j][1] * v[j][1]) + (v[j][2] * v[j][2] + v[j][3] * v[j][3]); }
        s = wave_sum(s);
        if (lane == 0) rstd1[m] = 1.0f / sqrtf(s * (1.0f / DM) + EPS);
        u32x2* o = (u32x2*)(XB + (size_t)m * DM) + lane;
#pragma unroll
        for (int j = 0; j < 8; ++j) { u32x2 w; w.x = cvt_pk_bf16(v[j][0], v[j][1]); w.y = cvt_pk_bf16(v[j][2], v[j][3]); o[64 * j] = w; }
    }
}

__device__ __forceinline__ int t5_bucket(int rel) {
    const int n = rel < 0 ? -rel : rel; int bkt;
    if (n < 8) bkt = n;
    else { int k = 0; while (k < 7 && (128 << k) <= n * n) ++k;
           bkt = 8 + k; if (bkt > 15) bkt = 15; }
    return bkt + (rel > 0 ? 16 : 0);
}

__device__ __forceinline__ void sgu_item(const Args& A, LAS unsigned char* lds, int it, int tid, int wave, int lane) {
    const int b = it >> 7, c = (it >> 3) & 15, g = it & 7, r0 = b * SEQ + c * 128;
    const bf16_t* Z = (const bf16_t*)(A.ws + WS_R2); bf16_t* AB = (bf16_t*)(A.ws + WS_R1); const float* vss = (const float*)(A.ws + WS_VSS);
    const float* gain = A.in[3]; const float* Ws = A.in[4] + (size_t)g * 128 * 128; const float* bs = A.in[5] + g * 128;
    LAS float* rsL = (LAS float*)(lds + SPARE_OFF);
    LAS unsigned* VT = (LAS unsigned*)lds;
    if (tid < 128) { const f32x4* p = (const f32x4*)(vss + (size_t)(r0 + tid) * 16); const f32x4 a = p[0], b2 = p[1], c2 = p[2], d2 = p[3];
        const float s = ((a[0] + a[1]) + (a[2] + a[3])) + ((b2[0] + b2[1]) + (b2[2] + b2[3])) + ((c2[0] + c2[1]) + (c2[2] + c2[3])) + ((d2[0] + d2[1]) + (d2[2] + d2[3]));
        rsL[tid] = 1.0f / sqrtf(s * (1.0f / 1024.0f) + EPS); }
    const int fr = lane & 15, fq = lane >> 4, p = 16 * wave + fr;
    bf16x8 wf[4];
#pragma unroll
    for (int s = 0; s < 4; ++s) { const f32x4 a = *(const f32x4*)(Ws + p * 128 + 32 * s + 8 * fq), b2 = *(const f32x4*)(Ws + p * 128 + 32 * s + 8 * fq + 4);
        u32x4 w; w.x = cvt_pk_bf16(a[0], a[1]); w.y = cvt_pk_bf16(a[2], a[3]); w.z = cvt_pk_bf16(b2[0], b2[1]); w.w = cvt_pk_bf16(b2[2], b2[3]); wf[s] = __builtin_bit_cast(bf16x8, w); }
    LDS_WAIT(); __syncthreads();
#pragma unroll
    for (int k = 0; k < 2; ++k) {
        const int task = tid + 512 * k, qp = task & 63, ec = task >> 6;
        const u32x4 a = *(const u32x4*)(Z + (size_t)(r0 + 2 * qp) * ZA_LD + ZC_V + g * 128 + 8 * ec), b2 = *(const u32x4*)(Z + (size_t)(r0 + 2 * qp + 1) * ZA_LD + ZC_V + g * 128 + 8 * ec);
        const float s0 = rsL[2 * qp], s1 = rsL[2 * qp + 1];
#pragma unroll
        for (int w = 0; w < 4; ++w) {
            VT[(8 * ec + 2 * w) * 68 + qp] = cvt_pk_bf16(bf_lo(a[w]) * s0, bf_lo(b2[w]) * s1);
            VT[(8 * ec + 2 * w + 1) * 68 + qp] = cvt_pk_bf16(bf_hi(a[w]) * s0, bf_hi(b2[w]) * s1);
        }
    }
    LDS_WAIT(); __syncthreads();
    f32x4 acc[8];
#pragma unroll
    for (int t = 0; t < 8; ++t) {
        acc[t] = (f32x4){0.f, 0.f, 0.f, 0.f};
#pragma unroll
        for (int s = 0; s < 4; ++s) { const bf16x8 vf = *(const LAS bf16x8*)(VT + (16 * t + fr) * 68 + 16 * s + 4 * fq);
            acc[t] = __builtin_amdgcn_mfma_f32_16x16x32_bf16(vf, wf[s], acc[t], 0, 0, 0); }
    }
    const float bp = bs[p];
#pragma unroll
    for (int t = 0; t < 8; ++t) {
        const int e = g * 128 + 16 * t + 4 * fq;
        const u32x2 uu = *(const u32x2*)(Z + (size_t)(r0 + p) * ZA_LD + ZC_U + e); const f32x4 gn = *(const f32x4*)(gain + e);
        const float y0 = bf_lo(uu.x) * (gn[0] * acc[t][0] + bp), y1 = bf_hi(uu.x) * (gn[1] * acc[t][1] + bp), y2 = bf_lo(uu.y) * (gn[2] * acc[t][2] + bp), y3 = bf_hi(uu.y) * (gn[3] * acc[t][3] + bp);
        u32x2 w; w.x = cvt_pk_bf16(y0, y1); w.y = cvt_pk_bf16(y2, y3);
        *(u32x2*)(AB + (size_t)(r0 + p) * DM + e) = w;
    }
    LDS_WAIT(); __syncthreads();
}

__device__ __forceinline__ void attn_item(const Args& A, LAS unsigned char* lds, int it, int tid, int wave, int lane) {
    const int b = it >> 7, n = (it >> 3) & 15, h = it & 7, kv = h >> 2, r0 = b * SEQ + n * 128;
    const bf16_t* Z = (const bf16_t*)(A.ws + WS_R2); bf16_t* AB = (bf16_t*)(A.ws + WS_R1);
    const float* sink = A.in[7]; const float* rel_bias = A.in[8];
    LAS float* biasL = (LAS float*)(lds + SPARE_OFF);
    LAS unsigned char* Kimg = lds;
    LAS unsigned* VT = (LAS unsigned*)lds;
    const int fr = lane & 15, fq = lane >> 4, q = 16 * wave + fr;
    for (int i = tid; i < 544; i += 512) { const int d = i - 128; biasL[i] = (d >= 0 && d <= 256) ? rel_bias[t5_bucket(d - 128) * 8 + h] : 0.f; }
#pragma unroll
    for (int k = 0; k < 12; ++k) {
        const int piece = tid + 512 * k, row = piece >> 4, ch = piece & 15;
        int gr = r0 - 128 + row; gr = gr < 0 ? 0 : (gr > MTOK - 1 ? MTOK - 1 : gr);
        const u32x4 v = *(const u32x4*)(Z + (size_t)gr * ZA_LD + ZC_K + kv * 128 + ch * 8);
        *(LAS u32x4*)(Kimg + row * 272 + ch * 16) = v;
    }
    bf16x8 qf[4];
#pragma unroll
    for (int s = 0; s < 4; ++s) qf[s] = *(const bf16x8*)(Z + (size_t)(r0 + q) * ZA_LD + ZC_Q + h * 128 + 32 * s + 8 * fq);
    LDS_WAIT(); __syncthreads();
    f32x4 sc[12][2];
#pragma unroll
    for (int blk = 0; blk < 12; ++blk)
#pragma unroll
        for (int tt = 0; tt < 2; ++tt) {
            const int key = 32 * blk + 8 * (fr >> 2) + (fr & 3) + 4 * tt;
            f32x4 a = (f32x4){0.f, 0.f, 0.f, 0.f};
#pragma unroll
            for (int s = 0; s < 4; ++s) { const bf16x8 kf = *(const LAS bf16x8*)(Kimg + key * 272 + 64 * s + 16 * fq);
                a = __builtin_amdgcn_mfma_f32_16x16x32_bf16(kf, qf[s], a, 0, 0, 0); }
            sc[blk][tt] = a;
        }
    const float sk = sink[h]; float mx = sk;
    const float scale = 0.08838834764831845f;
    const int dbase = 8 * fq - q; const LAS float* biasB = biasL + (128 + dbase);
#pragma unroll
    for (int blk = 0; blk < 12; ++blk)
#pragma unroll
        for (int tt = 0; tt < 2; ++tt)
#pragma unroll
            for (int j = 0; j < 4; ++j) {
                const int cb = n - 1 + (blk >> 2), dk = dbase + (32 * blk + 4 * tt + j);
                const float bv = biasB[32 * blk + 4 * tt + j];
                float s = sc[blk][tt][j] * scale + bv;
                s = ((unsigned)dk <= 256u && cb >= 0 && cb < 16) ? s : -1e30f;
                sc[blk][tt][j] = s; mx = fmaxf(mx, s);
            }
    mx = fmaxf(mx, __shfl_xor(mx, 16)); mx = fmaxf(mx, __shfl_xor(mx, 32));
    float l = 0.f; bf16x8 pb[12];
#pragma unroll
    for (int blk = 0; blk < 12; ++blk) {
        float e[8];
#pragma unroll
        for (int tt = 0; tt < 2; ++tt)
#pragma unroll
            for (int j = 0; j < 4; ++j) { e[4 * tt + j] = __builtin_amdgcn_exp2f((sc[blk][tt][j] - mx) * LOG2E); l += e[4 * tt + j]; }
        u32x4 w; w.x = cvt_pk_bf16(e[0], e[1]); w.y = cvt_pk_bf16(e[2], e[3]); w.z = cvt_pk_bf16(e[4], e[5]); w.w = cvt_pk_bf16(e[6], e[7]);
        pb[blk] = __builtin_bit_cast(bf16x8, w);
    }
    l += __shfl_xor(l, 16); l += __shfl_xor(l, 32);
    l += __builtin_amdgcn_exp2f((sk - mx) * LOG2E);
    const float inv = 1.0f / l;
    __syncthreads();
#pragma unroll
    for (int k = 0; k < 6; ++k) {
        const int task = tid + 512 * k, kp = task % 192, dc = task / 192, row = 2 * kp;
        int gr = r0 - 128 + row; gr = gr < 0 ? 0 : (gr > MTOK - 2 ? MTOK - 2 : gr);
        const u32x4 a = *(const u32x4*)(Z + (size_t)gr * ZA_LD + ZC_VV + kv * 128 + dc * 8), b2 = *(const u32x4*)(Z + (size_t)(gr + 1) * ZA_LD + ZC_VV + kv * 128 + dc * 8);
#pragma unroll
        for (int w = 0; w < 4; ++w) {
            VT[(8 * dc + 2 * w) * 196 + kp] = (a[w] & 0xffffu) | (b2[w] << 16);
            VT[(8 * dc + 2 * w + 1) * 196 + kp] = (a[w] >> 16) | (b2[w] & 0xffff0000u);
        }
    }
    LDS_WAIT(); __syncthreads();
#pragma unroll
    for (int dt = 0; dt < 8; ++dt) {
        f32x4 o = (f32x4){0.f, 0.f, 0.f, 0.f};
#pragma unroll
        for (int blk = 0; blk < 12; ++blk) { const bf16x8 vf = *(const LAS bf16x8*)(VT + (16 * dt + fr) * 196 + 16 * blk + 4 * fq);
            o = __builtin_amdgcn_mfma_f32_16x16x32_bf16(vf, pb[blk], o, 0, 0, 0); }
        u32x2 w; w.x = cvt_pk_bf16(o[0] * inv, o[1] * inv); w.y = cvt_pk_bf16(o[2] * inv, o[3] * inv);
        *(u32x2*)(AB + (size_t)(r0 + q) * DM + 1024 + h * 128 + 16 * dt + 4 * fq) = w;
    }
    LDS_WAIT(); __syncthreads();
}

__global__ void __launch_bounds__(NWAVES * 64, 2) enc_fwd(Args args) {
    extern __shared__ __attribute__((aligned(16))) unsigned char lds_raw[];
    LAS unsigned char* lds = (LAS unsigned char*)lds_raw;
    volatile LAS unsigned* MISC = (volatile LAS unsigned*)(lds + MISC_OFF);
    const int tid = threadIdx.x, lane = tid & 63, wave = __builtin_amdgcn_readfirstlane(tid >> 6);
    const int G = gridDim.x;
    unsigned char* ws = args.ws;
    if (tid < 64) MISC[tid] = 0u;
    __syncthreads();
    const int lo = args.ph_lo, hi = args.ph_hi;
    XcdBarrier bar; bar.bar = (unsigned*)(ws + WS_CTL); bar.x = 0; bar.st = nullptr;
    if (hi - lo > 1) bar = xcd_barrier_post((unsigned*)(ws + WS_CTL), MISC + 8);
#ifndef PHASE_MASK
#define PHASE_MASK 0xFF
#endif
#define IN(k) (((PHASE_MASK >> (k)) & 1) && lo <= (k) && (k) < hi)
#define SEAM(k) do { if (IN(k) && IN((k) + 1)) xcd_barrier(bar); } while (0)

    bf16_t* R1 = (bf16_t*)(ws + WS_R1); bf16_t* Z = (bf16_t*)(ws + WS_R2);
    if (IN(0)) { p0_prologue(args, lds, wave, lane); SEAM(0); }

    if (IN(1)) {
        pg8::Gemm g{R1, (const bf16_t*)(ws + WS_WIN), MTOK, NIN, DM}; pg8::StaticOrder S; S.init(MTOK, NIN, G, (int)blockIdx.x);
        Epi1 E{0, Z, (bf16_t*)(ws + WS_ZG), (const float*)(ws + WS_RSTD1), (float*)(ws + WS_VSS)};
        pg8::gemm_phase<Epi1>(lds, g, S, E);
        SEAM(1);
    }
    if (IN(2)) {
        for (int it = blockIdx.x; it < 1024; it += G) { if (it < 512) attn_item(args, lds, it, tid, wave, lane); else sgu_item(args, lds, it - 512, tid, wave, lane); }
        SEAM(2);
    }
    if (IN(3)) {
        pg8::Gemm g{R1, (const bf16_t*)(ws + WS_WAB), MTOK, DM, DM}; pg8::StaticOrder S; S.init(MTOK, DM, G, (int)blockIdx.x);
        Epi3 E{16, (const bf16_t*)(ws + WS_ZG), Z  };
        pg8::gemm_phase<Epi3>(lds, g, S, E);
        SEAM(3);
    }
    if (IN(4)) {
        pg8::Gemm g{Z  , (const bf16_t*)(ws + WS_WO), MTOK, DM, DM}; pg8::StaticOrder S; S.init(MTOK, DM, G, (int)blockIdx.x);
        EpiRes<true> E{0, args.in[0], args.out, R1, (float*)(ws + WS_X1SS)};
        pg8::gemm_phase<EpiRes<true>>(lds, g, S, E);
        SEAM(4);
    }
    if (IN(5)) {
        pg8::Gemm g{R1, (const bf16_t*)(ws + WS_WGU), MTOK, NGU, DM}; pg8::StaticOrder S; S.init(MTOK, NGU, G, (int)blockIdx.x);
        Epi5 E{0, (const float*)(ws + WS_X1SS), Z};
        pg8::gemm_phase<Epi5>(lds, g, S, E);
        SEAM(5);
    }
    if (IN(6)) {
        pg8::Gemm g{Z, (const bf16_t*)(ws + WS_WD), MTOK, DM, DFF}; pg8::StaticOrder S; S.init(MTOK, DM, G, (int)blockIdx.x);
        EpiRes<false> E{0, args.out, args.out, nullptr, (float*)(ws + WS_X2SS)};
        pg8::gemm_phase<EpiRes<false>>(lds, g, S, E);
        SEAM(6);
    }
    if (IN(7)) {
        const float* ss = (const float*)(ws + WS_X2SS); const float* gf = args.in[15];
        const int gw = blockIdx.x * NWAVES + wave, NGW = G * NWAVES;
        for (int m = gw; m < MTOK; m += NGW) {
            const f32x4 pa = *(const f32x4*)(ss + (size_t)m * 8), pb = *(const f32x4*)(ss + (size_t)m * 8 + 4);
            const float rs = 1.0f / sqrtf(((pa[0] + pa[1]) + (pa[2] + pa[3]) + (pb[0] + pb[1]) + (pb[2] + pb[3])) * (1.0f / DM) + EPS);
            f32x4* xr = (f32x4*)(args.out + (size_t)m * DM) + lane; const f32x4* gr = (const f32x4*)gf + lane;
#pragma unroll
            for (int j = 0; j < 8; ++j) { const f32x4 v = xr[64 * j], gg = gr[64 * j]; xr[64 * j] = v * rs * gg; }
        }
    }
#undef IN
#undef SEAM
}

extern "C" void kernel_launch(void* const* d_in, const int* in_sizes, int n_in, void* d_out, int out_size, void* d_ws, size_t ws_size, hipStream_t stream) {
    static int grid = 0;
    if (grid == 0) {
        if (n_in != 16 || in_sizes[0] != MTOK * DM || out_size != MTOK * DM || ws_size < WS_END) { fprintf(stderr, "kernel_launch: unexpected shapes / workspace (%zu < %zu)\n", ws_size, (size_t)WS_END); grid = -1; return; }
        int dev = 0, cus = 0, per_cu = 0;
        if (hipGetDevice(&dev) != hipSuccess || hipDeviceGetAttribute(&cus, hipDeviceAttributeMultiprocessorCount, dev) != hipSuccess) { grid = -1; return; }
        if (hipFuncSetAttribute((const void*)enc_fwd, hipFuncAttributeMaxDynamicSharedMemorySize, LDS_BYTES) != hipSuccess) { fprintf(stderr, "kernel_launch: hipFuncSetAttribute failed\n"); grid = -1; return; }
        if (hipOccupancyMaxActiveBlocksPerMultiprocessor(&per_cu, (const void*)enc_fwd, NWAVES * 64, LDS_BYTES) != hipSuccess || per_cu < 1) { fprintf(stderr, "kernel_launch: occupancy query says %d\n", per_cu); per_cu = 1; }
        (void)hipGetLastError();
        grid = cus;
    }
    if (grid < 0) return;
    (void)hipMemsetAsync((char*)d_ws + WS_CTL, 0, CTL_ZERO_BYTES, stream);
    Args a{};
    for (int i = 0; i < 16; ++i) a.in[i] = (const float*)d_in[i];
    a.out = (float*)d_out; a.ws = (unsigned char*)d_ws;
    if (MK_N_LAUNCHES == 1) { a.ph_lo = 0; a.ph_hi = 8; hipLaunchKernelGGL(enc_fwd, dim3(grid), dim3(NWAVES * 64), LDS_BYTES, stream, a); }
    else for (int p = 0; p < 8; ++p) { a.ph_lo = p; a.ph_hi = p + 1; hipLaunchKernelGGL(enc_fwd, dim3(grid), dim3(NWAVES * 64), LDS_BYTES, stream, a); }
}
```
